# Optimizing an MI355X kernel written in HIP

```python
import math
import jax, jax.numpy as jnp
from jax import lax
import numpy as np

D_MODEL = 1024
BATCH = 4
SEQ = 8192
DEPTH = 1

DA_HEADS = 8
DA_HEAD_DIM = 64
DA_V_DIM = 2 * DA_HEAD_DIM
DA_QK_WIDTH = 2 * DA_HEADS * DA_HEAD_DIM
DA_WIDTH = DA_HEADS * DA_V_DIM
GLA_HEADS = 4
GLA_K_DIM = 128
GLA_V_DIM = 256
GLA_QK_WIDTH = GLA_HEADS * GLA_K_DIM
GLA_WIDTH = GLA_HEADS * GLA_V_DIM
GLA_GATE_RANK = 16
GLA_GATE_NORMALIZER = 16.0
GLA_CHUNK = 64

MIX_WIDTH = DA_WIDTH + GLA_WIDTH
Q_BLOCK = 128
NORM_EPS = 1e-6
IN_SPLITS = (DA_QK_WIDTH, DA_QK_WIDTH, DA_WIDTH, DA_WIDTH,
             GLA_QK_WIDTH, GLA_QK_WIDTH, GLA_WIDTH, GLA_WIDTH, GLA_GATE_RANK)
IN_WIDTH = sum(IN_SPLITS)

kernel_name = "hymba_diffattn_gla_sandwich"


def rms_norm(x, g):
    xf = x.astype(jnp.float32)
    y = xf * lax.rsqrt(jnp.mean(xf * xf, axis=-1, keepdims=True) + NORM_EPS)
    return (y * g.astype(jnp.float32)).astype(x.dtype)


def split_columns(z):
    parts, start = [], 0
    for w in IN_SPLITS:
        parts.append(z[..., start:start + w])
        start += w
    return parts


def diff_attention(q, k, v, lam):
    B, S = q.shape[:2]
    nb = S // Q_BLOCK
    q = q * (DA_HEAD_DIM ** -0.5)
    q_blocks = jnp.moveaxis(q.reshape(B, nb, Q_BLOCK, DA_HEADS, 2, DA_HEAD_DIM), 1, 0)
    key_pos = jnp.arange(S)

    def block(args):
        qb, bi = args
        s = jnp.einsum('bqhmd,bkhmd->bhmqk', qb, k).astype(jnp.float32)
        q_pos = bi * Q_BLOCK + jnp.arange(Q_BLOCK)
        mask = key_pos[None, :] <= q_pos[:, None]
        p = jax.nn.softmax(jnp.where(mask, s, -jnp.inf), axis=-1)
        w = p[:, :, 0] - lam * p[:, :, 1]
        return jnp.einsum('bhqk,bkhv->bqhv', w.astype(v.dtype), v)

    out = lax.map(block, (q_blocks, jnp.arange(nb)))
    return jnp.moveaxis(out, 0, 1).reshape(B, S, DA_HEADS, DA_V_DIM)


def gla_chunked(q, k, v, log_a):
    B, S, H, dk = q.shape
    dv = v.shape[-1]
    C = GLA_CHUNK
    N = S // C
    f32 = jnp.float32

    def chunks(t):
        return t.astype(f32).reshape(B, N, C, H, t.shape[-1]).transpose(0, 3, 1, 2, 4)

    q = chunks(q) * (dk ** -0.5)
    k = chunks(k)
    v = chunks(v)
    b = jnp.cumsum(chunks(log_a), axis=3)
    b_last = b[:, :, :, -1, :]
    q_dec = q * jnp.exp(b)
    k_inv = k * jnp.exp(-b)
    k_tail = k * jnp.exp(b_last[:, :, :, None, :] - b)

    causal = jnp.tril(jnp.ones((C, C), dtype=bool))
    attn = jnp.where(causal, jnp.einsum('bhnik,bhnjk->bhnij', q_dec, k_inv), 0.0)
    o_intra = jnp.einsum('bhnij,bhnjv->bhniv', attn, v)

    def step(state, xs):
        qd, kt, vc, dl = xs
        o = jnp.einsum('bhck,bhkv->bhcv', qd, state)
        state = state * dl[..., None] + jnp.einsum('bhck,bhcv->bhkv', kt, vc)
        return state, o

    xs = (jnp.moveaxis(q_dec, 2, 0), jnp.moveaxis(k_tail, 2, 0),
          jnp.moveaxis(v, 2, 0), jnp.moveaxis(jnp.exp(b_last), 2, 0))
    state0 = jnp.zeros((B, H, dk, dv), f32)
    _, o_inter = lax.scan(step, state0, xs)
    o = o_intra + jnp.moveaxis(o_inter, 0, 2)
    return o.transpose(0, 2, 3, 1, 4).reshape(B, S, H, dv)


def hybrid_layer(x, layer_idx, pre_g, post_g, w_in, w_gk_up, b_gk,
                 lq1, lk1, lq2, lk2, subln_g, gla_g, w_out):
    B, S, _ = x.shape
    h = rms_norm(x, pre_g)
    z = jnp.einsum('bsd,de->bse', h, w_in)
    qa, ka, va, ga, qb, kb, vb, gb, gk_low = split_columns(z)

    lam_init = 0.8 - 0.6 * math.exp(-0.3 * layer_idx)
    lam = (jnp.exp(jnp.sum(lq1.astype(jnp.float32) * lk1.astype(jnp.float32)))
           - jnp.exp(jnp.sum(lq2.astype(jnp.float32) * lk2.astype(jnp.float32)))
           + lam_init)
    oa = diff_attention(qa.reshape(B, S, DA_HEADS, 2, DA_HEAD_DIM),
                        ka.reshape(B, S, DA_HEADS, 2, DA_HEAD_DIM),
                        va.reshape(B, S, DA_HEADS, DA_V_DIM), lam)
    oa = rms_norm(oa, subln_g) * (1.0 - lam_init)
    oa = oa.reshape(B, S, DA_WIDTH) * jax.nn.silu(ga)

    gk = jnp.einsum('bsr,re->bse', gk_low, w_gk_up) + b_gk
    log_a = jax.nn.log_sigmoid(gk.astype(jnp.float32)) / GLA_GATE_NORMALIZER
    ob = gla_chunked(qb.reshape(B, S, GLA_HEADS, GLA_K_DIM),
                     kb.reshape(B, S, GLA_HEADS, GLA_K_DIM),
                     vb.reshape(B, S, GLA_HEADS, GLA_V_DIM),
                     log_a.reshape(B, S, GLA_HEADS, GLA_K_DIM))
    ob = rms_norm(ob, gla_g).astype(x.dtype)
    ob = ob.reshape(B, S, GLA_WIDTH) * jax.nn.silu(gb)

    y = jnp.einsum('bse,ed->bsd', jnp.concatenate([oa, ob], axis=-1), w_out)
    return x + rms_norm(y, post_g)


def setup_inputs(seed: int = 0) -> dict:
    key = jax.random.key(seed)
    ks = jax.random.split(key, 14)
    f32 = jnp.float32
    L = DEPTH
    return {
        "x": jax.random.normal(ks[0], (BATCH, SEQ, D_MODEL), f32),
        "pre_norm_g": 1.0 + 0.02 * jax.random.normal(ks[1], (L, D_MODEL), f32),
        "post_norm_g": 1.0 + 0.02 * jax.random.normal(ks[2], (L, D_MODEL), f32),
        "w_in": jax.random.normal(ks[3], (L, D_MODEL, IN_WIDTH), f32) * D_MODEL ** -0.5,
        "w_gk_up": jax.random.normal(ks[4], (L, GLA_GATE_RANK, GLA_QK_WIDTH), f32) * GLA_GATE_RANK ** -0.5,
        "b_gk": 0.01 * jax.random.normal(ks[5], (L, GLA_QK_WIDTH), f32),
        "lambda_q1": 0.1 * jax.random.normal(ks[6], (L, DA_HEAD_DIM), f32),
        "lambda_k1": 0.1 * jax.random.normal(ks[7], (L, DA_HEAD_DIM), f32),
        "lambda_q2": 0.1 * jax.random.normal(ks[8], (L, DA_HEAD_DIM), f32),
        "lambda_k2": 0.1 * jax.random.normal(ks[9], (L, DA_HEAD_DIM), f32),
        "attn_subln_g": 1.0 + 0.02 * jax.random.normal(ks[10], (L, DA_V_DIM), f32),
        "gla_norm_g": 1.0 + 0.02 * jax.random.normal(ks[11], (L, GLA_V_DIM), f32),
        "w_out": jax.random.normal(ks[12], (L, MIX_WIDTH, D_MODEL), f32) * MIX_WIDTH ** -0.5,
    }


def reference(x, pre_norm_g, post_norm_g, w_in, w_gk_up, b_gk, lambda_q1, lambda_k1,
              lambda_q2, lambda_k2, attn_subln_g, gla_norm_g, w_out):
    for l in range(DEPTH):
        x = hybrid_layer(x, l, pre_norm_g[l], post_norm_g[l], w_in[l], w_gk_up[l], b_gk[l],
                         lambda_q1[l], lambda_k1[l], lambda_q2[l], lambda_k2[l],
                         attn_subln_g[l], gla_norm_g[l], w_out[l])
    return x
```

```cpp
#include <hip/hip_runtime.h>
#include <cstdio>
#include <cstdint>

typedef unsigned short bf16_t;
typedef short bf16x8 __attribute__((ext_vector_type(8)));
typedef float f32x4 __attribute__((ext_vector_type(4)));

constexpr int BATCH = 4, SEQ = 8192, DM = 1024, M = BATCH * SEQ;
constexpr int INW = 7184, NZ = 7168;
constexpr int ZQA = 0, ZKA = 1024, ZVA = 2048, ZQB = 3072, ZKB = 3584, ZVB = 4096, ZGA = 5120, ZGB = 6144;
constexpr float EPS = 1e-6f;
constexpr float C2 = 0.125f * 1.4426950408889634f;
constexpr size_t MiB = 1u << 20;
constexpr size_t WS_WIN = 1 * MiB, WS_WOUT = 16 * MiB, WS_GKL = 20 * MiB, WS_Z = 32 * MiB, WS_END = 480 * MiB;

__device__ __forceinline__ unsigned f2bf(float f) { unsigned u = __float_as_uint(f); return (u + 0x7fffu + ((u >> 16) & 1u)) >> 16; }
__device__ __forceinline__ float bf2f(bf16_t b) { return __uint_as_float(((unsigned)b) << 16); }
__device__ __forceinline__ float wave_sum(float v) {
#pragma unroll
    for (int o = 1; o < 64; o <<= 1) v += __shfl_xor(v, o);
    return v;
}
__device__ __forceinline__ int orig_col(int c) { return c < 3072 ? c : (c < 5120 ? c + 1024 : (c < 6144 ? c - 2048 : c)); }

__global__ void k_prep(const float* __restrict__ w_in, const float* __restrict__ w_out, bf16_t* __restrict__ wt_in, bf16_t* __restrict__ wt_out) {
    const size_t i = (size_t)blockIdx.x * 256 + threadIdx.x;
    const size_t n1 = (size_t)NZ * DM;
    if (i < n1) { const int k = (int)(i / NZ), n = (int)(i % NZ); wt_in[(size_t)n * DM + k] = (bf16_t)f2bf(w_in[(size_t)k * INW + orig_col(n)]); }
    else { const size_t j = i - n1; if (j < (size_t)2048 * 1024) { const int k = (int)(j / 1024), n = (int)(j % 1024); wt_out[(size_t)n * 2048 + k] = (bf16_t)f2bf(w_out[(size_t)k * 1024 + n]); } }
}

__global__ void k_norm(const float* __restrict__ x, const float* __restrict__ g, const float* __restrict__ w_in, bf16_t* __restrict__ xn, float* __restrict__ gkl) {
    const int lane = threadIdx.x & 63, row = blockIdx.x * 4 + (threadIdx.x >> 6);
    const float* xr = x + (size_t)row * DM;
    float h[16]; float ss = 0.f;
#pragma unroll
    for (int j = 0; j < 4; ++j) { const f32x4 v = *(const f32x4*)(xr + j * 256 + lane * 4); h[4 * j] = v[0]; h[4 * j + 1] = v[1]; h[4 * j + 2] = v[2]; h[4 * j + 3] = v[3]; ss += v[0] * v[0] + v[1] * v[1] + v[2] * v[2] + v[3] * v[3]; }
    ss = wave_sum(ss);
    const float rstd = rsqrtf(ss * (1.f / DM) + EPS);
#pragma unroll
    for (int j = 0; j < 4; ++j) {
        const f32x4 gv = *(const f32x4*)(g + j * 256 + lane * 4);
#pragma unroll
        for (int e = 0; e < 4; ++e) h[4 * j + e] = h[4 * j + e] * rstd * gv[e];
        unsigned lo = f2bf(h[4 * j]) | (f2bf(h[4 * j + 1]) << 16), hi = f2bf(h[4 * j + 2]) | (f2bf(h[4 * j + 3]) << 16);
        *(uint2*)(xn + (size_t)row * DM + j * 256 + lane * 4) = make_uint2(lo, hi);
    }
    __shared__ float hs[4][DM];
    float* hw = hs[threadIdx.x >> 6];
#pragma unroll
    for (int j = 0; j < 4; ++j)
#pragma unroll
        for (int e = 0; e < 4; ++e) hw[j * 256 + lane * 4 + e] = h[4 * j + e];
    __syncthreads();
    const int c = lane & 15, kq = lane >> 4;
    float acc = 0.f;
#pragma unroll 4
    for (int k = kq * 256; k < kq * 256 + 256; ++k) acc += hw[k] * w_in[(size_t)k * INW + 7168 + c];
    acc += __shfl_xor(acc, 16); acc += __shfl_xor(acc, 32);
    if (lane < 16) gkl[(size_t)row * 16 + c] = acc;
}

template <int MODE> __global__ void __launch_bounds__(256) k_gemm(const bf16_t* __restrict__ A, int lda, const bf16_t* __restrict__ Bt, int K, void* __restrict__ Cout, int ldc) {
    const int lane = threadIdx.x & 63, w = threadIdx.x >> 6, fr = lane & 15, fq = lane >> 4;
    const int row0 = blockIdx.y * 128 + (w >> 1) * 64, col0 = blockIdx.x * 128 + (w & 1) * 64;
    f32x4 acc[4][4];
#pragma unroll
    for (int i = 0; i < 4; ++i)
#pragma unroll
        for (int j = 0; j < 4; ++j) acc[i][j] = (f32x4){0.f, 0.f, 0.f, 0.f};
    const bf16_t* ap = A + (size_t)(row0 + fr) * lda + fq * 8;
    const bf16_t* bp = Bt + (size_t)(col0 + fr) * K + fq * 8;
    for (int k0 = 0; k0 < K; k0 += 32) {
        bf16x8 a[4], b[4];
#pragma unroll
        for (int i = 0; i < 4; ++i) { a[i] = *(const bf16x8*)(ap + (size_t)i * 16 * lda + k0); b[i] = *(const bf16x8*)(bp + (size_t)i * 16 * K + k0); }
#pragma unroll
        for (int i = 0; i < 4; ++i)
#pragma unroll
            for (int j = 0; j < 4; ++j) acc[i][j] = __builtin_amdgcn_mfma_f32_16x16x32_bf16(a[i], b[j], acc[i][j], 0, 0, 0);
    }
#pragma unroll
    for (int i = 0; i < 4; ++i)
#pragma unroll
        for (int j = 0; j < 4; ++j)
#pragma unroll
            for (int r = 0; r < 4; ++r) {
                const int row = row0 + i * 16 + fq * 4 + r, col = col0 + j * 16 + fr;
                if (MODE == 0) { const float sc = col < 1024 ? C2 : 1.f; ((bf16_t*)Cout)[(size_t)row * ldc + col] = (bf16_t)f2bf(acc[i][j][r] * sc); }
                else ((float*)Cout)[(size_t)row * ldc + col] = acc[i][j][r];
            }
}

__global__ void __launch_bounds__(256) k_attn(const bf16_t* __restrict__ z, bf16_t* __restrict__ opart) {
    const int lane = threadIdx.x & 63, w = threadIdx.x >> 6;
    const int qblk = blockIdx.x, hh = blockIdx.y, b = blockIdx.z, h = hh >> 1, m = hh & 1;
    const int i = qblk * 64 + lane; const size_t R = (size_t)b * SEQ + i;
    float q[64];
#pragma unroll
    for (int d = 0; d < 64; ++d) q[d] = bf2f(z[R * NZ + ZQA + hh * 64 + d]);
    float o[32];
#pragma unroll
    for (int c = 0; c < 32; ++c) o[c] = 0.f;
    float mx = -INFINITY, l = 0.f;
    const int jend = qblk * 64 + 63;
    for (int j = 0; j <= jend; ++j) {
        const bf16_t* kr = z + ((size_t)b * SEQ + j) * NZ + ZKA + hh * 64;
        const bf16_t* vr = z + ((size_t)b * SEQ + j) * NZ + ZVA + h * 128 + w * 32;
        float s = 0.f;
#pragma unroll
        for (int d = 0; d < 64; ++d) s += q[d] * bf2f(kr[d]);
        if (j <= i) {
            const float mn = fmaxf(mx, s), corr = exp2f(mx - mn), p = exp2f(s - mn);
            l = l * corr + p;
#pragma unroll
            for (int c = 0; c < 32; ++c) o[c] = o[c] * corr + p * bf2f(vr[c]);
            mx = mn;
        }
    }
    const float rl = 1.f / l;
    bf16_t* op = opart + ((size_t)m * M + R) * 1024 + h * 128 + w * 32;
#pragma unroll
    for (int c = 0; c < 32; ++c) op[c] = (bf16_t)f2bf(o[c] * rl);
}

__device__ __forceinline__ float silu(float x) { return x / (1.f + __expf(-x)); }

__global__ void k_comb(const bf16_t* __restrict__ opart, bf16_t* __restrict__ z, const float* __restrict__ lq1, const float* __restrict__ lk1, const float* __restrict__ lq2, const float* __restrict__ lk2, const float* __restrict__ sg) {
    const int lane = threadIdx.x & 63, row = blockIdx.x * 4 + (threadIdx.x >> 6);
    const float d1 = wave_sum(lq1[lane] * lk1[lane]), d2 = wave_sum(lq2[lane] * lk2[lane]);
    const float lam = __expf(d1) - __expf(d2) + 0.2f;
    float t[16]; float ss = 0.f;
#pragma unroll
    for (int e = 0; e < 16; ++e) { const int c = lane * 16 + e; t[e] = bf2f(opart[(size_t)row * 1024 + c]) - lam * bf2f(opart[((size_t)M + row) * 1024 + c]); ss += t[e] * t[e]; }
    ss += __shfl_xor(ss, 1); ss += __shfl_xor(ss, 2); ss += __shfl_xor(ss, 4);
    const float rstd = rsqrtf(ss * (1.f / 128.f) + EPS);
#pragma unroll
    for (int e = 0; e < 16; ++e) { const int c = lane * 16 + e; bf16_t* gp = z + (size_t)row * NZ + ZGA + c; const float ga = bf2f(*gp); *gp = (bf16_t)f2bf(t[e] * rstd * sg[c & 127] * 0.8f * silu(ga)); }
}

__global__ void __launch_bounds__(256) k_gla(const bf16_t* __restrict__ z, const float* __restrict__ gkl, const float* __restrict__ w_up, const float* __restrict__ b_gk, float* __restrict__ oraw) {
    const int tid = threadIdx.x, kk = tid & 31, vv = tid >> 5;
    const int vg = blockIdx.x, h = blockIdx.y, b = blockIdx.z;
    const int k0 = h * 128 + kk * 4, vcol = h * 256 + vg * 8 + vv;
    float wu[16][4], bg[4], S[4] = {0.f, 0.f, 0.f, 0.f};
#pragma unroll
    for (int r = 0; r < 16; ++r)
#pragma unroll
        for (int i = 0; i < 4; ++i) wu[r][i] = w_up[r * 512 + k0 + i];
#pragma unroll
    for (int i = 0; i < 4; ++i) bg[i] = b_gk[k0 + i];
    const float qs = 0.08838834764831845f;
    for (int t = 0; t < SEQ; ++t) {
        const size_t R = (size_t)b * SEQ + t;
        const float* gl = gkl + R * 16;
        float gk[4] = {bg[0], bg[1], bg[2], bg[3]};
#pragma unroll
        for (int r = 0; r < 16; ++r) { const float g = gl[r];
#pragma unroll
            for (int i = 0; i < 4; ++i) gk[i] += g * wu[r][i]; }
        const bf16_t* zr = z + R * NZ;
        const float v = bf2f(zr[ZVB + vcol]);
        float part = 0.f;
#pragma unroll
        for (int i = 0; i < 4; ++i) {
            const float x = gk[i];
            const float ls = fminf(x, 0.f) - log1pf(__expf(-fabsf(x)));
            const float a = __expf(ls * (1.f / 16.f));
            const float qv = bf2f(zr[ZQB + k0 + i]) * qs, kv = bf2f(zr[ZKB + k0 + i]);
            S[i] = a * S[i] + kv * v;
            part += qv * S[i];
        }
        part += __shfl_xor(part, 1); part += __shfl_xor(part, 2); part += __shfl_xor(part, 4); part += __shfl_xor(part, 8); part += __shfl_xor(part, 16);
        if (kk == 0) oraw[R * 1024 + vcol] = part;
    }
}

__global__ void k_gla_norm(const float* __restrict__ oraw, bf16_t* __restrict__ z, const float* __restrict__ gg) {
    const int lane = threadIdx.x & 63, row = blockIdx.x * 4 + (threadIdx.x >> 6);
    float t[16]; float ss = 0.f;
#pragma unroll
    for (int e = 0; e < 16; ++e) { t[e] = oraw[(size_t)row * 1024 + lane * 16 + e]; ss += t[e] * t[e]; }
    ss += __shfl_xor(ss, 1); ss += __shfl_xor(ss, 2); ss += __shfl_xor(ss, 4); ss += __shfl_xor(ss, 8);
    const float rstd = rsqrtf(ss * (1.f / 256.f) + EPS);
#pragma unroll
    for (int e = 0; e < 16; ++e) { const int c = lane * 16 + e; bf16_t* gp = z + (size_t)row * NZ + ZGB + c; const float gb = bf2f(*gp); *gp = (bf16_t)f2bf(t[e] * rstd * gg[c & 255] * silu(gb)); }
}

__global__ void k_final(const float* __restrict__ x, const float* __restrict__ g, float* __restrict__ out) {
    const int lane = threadIdx.x & 63, row = blockIdx.x * 4 + (threadIdx.x >> 6);
    f32x4 v[4]; float ss = 0.f;
#pragma unroll
    for (int j = 0; j < 4; ++j) { v[j] = *(const f32x4*)(out + (size_t)row * DM + j * 256 + lane * 4); ss += v[j][0] * v[j][0] + v[j][1] * v[j][1] + v[j][2] * v[j][2] + v[j][3] * v[j][3]; }
    ss = wave_sum(ss);
    const float rstd = rsqrtf(ss * (1.f / DM) + EPS);
#pragma unroll
    for (int j = 0; j < 4; ++j) { const f32x4 gv = *(const f32x4*)(g + j * 256 + lane * 4), xv = *(const f32x4*)(x + (size_t)row * DM + j * 256 + lane * 4);
        *(f32x4*)(out + (size_t)row * DM + j * 256 + lane * 4) = xv + v[j] * rstd * gv; }
}

extern "C" void kernel_launch(void* const* d_in, const int* in_sizes, int n_in, void* d_out, int out_size, void* d_ws, size_t ws_size, hipStream_t stream) {
    if (n_in != 13 || out_size != M * DM || ws_size < WS_END) { fprintf(stderr, "kernel_launch: unexpected sizes n_in %d out %d ws %zu\n", n_in, out_size, ws_size); return; }
    const float* x = (const float*)d_in[0]; const float* pre_g = (const float*)d_in[1]; const float* post_g = (const float*)d_in[2];
    const float* w_in = (const float*)d_in[3]; const float* w_up = (const float*)d_in[4]; const float* b_gk = (const float*)d_in[5];
    const float* lq1 = (const float*)d_in[6]; const float* lk1 = (const float*)d_in[7]; const float* lq2 = (const float*)d_in[8]; const float* lk2 = (const float*)d_in[9];
    const float* sg = (const float*)d_in[10]; const float* gg = (const float*)d_in[11]; const float* w_out = (const float*)d_in[12];
    unsigned char* ws = (unsigned char*)d_ws;
    bf16_t* wt_in = (bf16_t*)(ws + WS_WIN); bf16_t* wt_out = (bf16_t*)(ws + WS_WOUT); float* gkl = (float*)(ws + WS_GKL); bf16_t* z = (bf16_t*)(ws + WS_Z);
    bf16_t* xn = (bf16_t*)d_out; bf16_t* opart = (bf16_t*)d_out; float* out = (float*)d_out;
    const size_t nprep = (size_t)NZ * DM + (size_t)2048 * 1024;
    k_prep<<<(unsigned)((nprep + 255) / 256), 256, 0, stream>>>(w_in, w_out, wt_in, wt_out);
    k_norm<<<M / 4, 256, 0, stream>>>(x, pre_g, w_in, xn, gkl);
    k_gemm<0><<<dim3(NZ / 128, M / 128), 256, 0, stream>>>(xn, DM, wt_in, DM, z, NZ);
    k_attn<<<dim3(SEQ / 64, 16, BATCH), 256, 0, stream>>>(z, opart);
    k_comb<<<M / 4, 256, 0, stream>>>(opart, z, lq1, lk1, lq2, lk2, sg);
    k_gla<<<dim3(32, 4, BATCH), 256, 0, stream>>>(z, gkl, w_up, b_gk, out);
    k_gla_norm<<<M / 4, 256, 0, stream>>>(out, z, gg);
    k_gemm<1><<<dim3(DM / 128, M / 128), 256, 0, stream>>>(z + ZGA, NZ, wt_out, 2048, out, DM);
    k_final<<<M / 4, 256, 0, stream>>>(x, post_g, out);
}
```
